# Optimizing an MI355X kernel written in HIP

```python
import jax
import jax.numpy as jnp
from jax import lax
import numpy as np

D_MODEL = 1024
BATCH = 4
SEQ = 4096
DEPTH = 2

EPS = 1e-6
N_MEM = 256
D_MIX = D_MODEL
POOL_WIDTH = D_MIX // 2
POOL_GROUPS = 4
POOL_GROUP_DIM = POOL_WIDTH // POOL_GROUPS
POOL_WINDOWS = (2, 4, 8, 16)
MLSTM_WIDTH = D_MIX - POOL_WIDTH
MLSTM_HEADS = 4
MLSTM_HEAD_DIM = MLSTM_WIDTH // MLSTM_HEADS
CONV_WIDTH = 4
CHUNK = 64
XATTN_HEADS = 4
XATTN_HEAD_DIM = D_MODEL // XATTN_HEADS
D_FF = -(-8 * D_MODEL // (3 * 256)) * 256

OFF_Q = POOL_WIDTH
OFF_K = OFF_Q + MLSTM_WIDTH
OFF_V = OFF_K + MLSTM_WIDTH
OFF_O = OFF_V + MLSTM_WIDTH
OFF_GATE = OFF_O + MLSTM_WIDTH
IN_COLS = OFF_GATE + 2 * MLSTM_HEADS

kernel_name = "hybrid_pool_mlstm_memxattn_block"


def rmsnorm(x, g):
    xf = x.astype(jnp.float32)
    y = xf * lax.rsqrt(jnp.mean(xf * xf, axis=-1, keepdims=True) + EPS)
    return (y * g.astype(jnp.float32)).astype(x.dtype)


def causal_depthwise_conv(x, w):
    C = x.shape[-1]
    return lax.conv_general_dilated(
        x, w[:, None, :].astype(x.dtype), window_strides=(1,),
        padding=[(CONV_WIDTH - 1, 0)], dimension_numbers=('NWC', 'WIO', 'NWC'),
        feature_group_count=C)


def pool_mixer(u, w_pool, scale):
    B, S, _ = u.shape
    uf = u.astype(jnp.float32).reshape(B, S, POOL_GROUPS, POOL_GROUP_DIM)
    cs = jnp.concatenate([jnp.zeros_like(uf[:, :1]), jnp.cumsum(uf, axis=1)], axis=1)
    t = jnp.arange(S)[:, None]
    win = jnp.asarray(POOL_WINDOWS, dtype=jnp.int32)[None, :]
    start = jnp.maximum(t + 1 - win, 0)
    count = (t + 1 - start).astype(jnp.float32)
    window_sum = cs[:, 1:] - cs[:, start, jnp.arange(POOL_GROUPS)[None, :], :]
    d = window_sum / count[None, :, :, None] - uf
    y = jnp.einsum('bsgc,gcd->bsgd', d, w_pool.astype(jnp.float32))
    return (y.reshape(B, S, POOL_WIDTH) * scale.astype(jnp.float32)).astype(u.dtype)


def _chunk_seq(t):
    B, H, S = t.shape[:3]
    t = t.reshape((B, H, S // CHUNK, CHUNK) + t.shape[3:])
    return jnp.moveaxis(t, 2, 0)


def mlstm_heads(q, k, v, i_pre, f_pre):
    B, S, H, dh = q.shape
    q = q * dh ** -0.5
    qc, kc, vc = (_chunk_seq(jnp.swapaxes(t, 1, 2)) for t in (q, k, v))
    ic = _chunk_seq(jnp.swapaxes(i_pre, 1, 2))
    fc = _chunk_seq(jnp.swapaxes(jax.nn.log_sigmoid(f_pre), 1, 2))
    tril = jnp.tril(jnp.ones((CHUNK, CHUNK), dtype=bool))

    def step(carry, inp):
        C, n, m = carry
        qb, kb, vb, ib, fb = inp
        b = jnp.cumsum(fb, axis=-1)
        D = jnp.where(tril, b[..., :, None] - b[..., None, :] + ib[..., None, :], -jnp.inf)
        inter = b + m[..., None]
        m_i = jnp.maximum(jnp.max(D, axis=-1), inter)
        A = jnp.einsum('bhid,bhjd->bhij', qb, kb) * jnp.exp(D - m_i[..., None])
        w_inter = jnp.exp(inter - m_i)
        num = jnp.einsum('bhij,bhjd->bhid', A, vb) + w_inter[..., None] * jnp.einsum('bhid,bhde->bhie', qb, C)
        den = jnp.sum(A, axis=-1) + w_inter * jnp.einsum('bhid,bhd->bhi', qb, n)
        h = num / jnp.maximum(jnp.abs(den), jnp.exp(-m_i))[..., None]
        bL = b[..., -1]
        g = bL[..., None] - b + ib
        m_new = jnp.maximum(bL + m, jnp.max(g, axis=-1))
        decay = jnp.exp(bL + m - m_new)
        wk = jnp.exp(g - m_new[..., None])
        C_new = decay[..., None, None] * C + jnp.einsum('bhj,bhjd,bhje->bhde', wk, kb, vb)
        n_new = decay[..., None] * n + jnp.einsum('bhj,bhjd->bhd', wk, kb)
        return (C_new, n_new, m_new), h

    init = (jnp.zeros((B, H, dh, dh), jnp.float32), jnp.zeros((B, H, dh), jnp.float32),
            jnp.zeros((B, H), jnp.float32))
    _, h = lax.scan(step, init, (qc, kc, vc, ic, fc))
    h = jnp.moveaxis(h, 0, 2).reshape(B, H, S, dh)
    return jnp.swapaxes(h, 1, 2)


def cross_attention(xn, mem_n, wq, wk, wv, wo):
    B, S, _ = xn.shape
    M = mem_n.shape[1]
    q = (xn @ wq).reshape(B, S, XATTN_HEADS, XATTN_HEAD_DIM).astype(jnp.float32)
    k = (mem_n @ wk).reshape(B, M, XATTN_HEADS, XATTN_HEAD_DIM).astype(jnp.float32)
    v = (mem_n @ wv).reshape(B, M, XATTN_HEADS, XATTN_HEAD_DIM).astype(jnp.float32)
    p = jax.nn.softmax(jnp.einsum('bshd,bmhd->bhsm', q, k) * XATTN_HEAD_DIM ** -0.5, axis=-1)
    o = jnp.einsum('bhsm,bmhd->bshd', p, v).reshape(B, S, D_MODEL).astype(xn.dtype)
    return o @ wo


def swiglu(xn, wg, wu, wd):
    return (jax.nn.silu(xn @ wg) * (xn @ wu)) @ wd


def setup_inputs(seed: int = 0) -> dict:
    key = jax.random.key(seed)
    ks = jax.random.split(key, 24)

    def nrm(k, shape, scale):
        return jax.random.normal(k, shape, jnp.float32) * scale

    def gain(k, shape):
        return 1.0 + 0.02 * jax.random.normal(k, shape, jnp.float32)

    H = MLSTM_HEADS
    b_i = nrm(ks[3], (DEPTH, H), 0.1)
    b_f = jnp.linspace(3.0, 6.0, H, dtype=jnp.float32)[None, :] + nrm(ks[4], (DEPTH, H), 0.1)
    return {
        'x': nrm(ks[0], (BATCH, SEQ, D_MODEL), 1.0),
        'mem': nrm(ks[1], (BATCH, N_MEM, D_MODEL), 1.0),
        'w_in': nrm(ks[2], (DEPTH, D_MODEL, IN_COLS), D_MODEL ** -0.5),
        'b_gate': jnp.concatenate([b_i, b_f], axis=-1),
        'conv_qk': nrm(ks[5], (DEPTH, CONV_WIDTH, 2 * MLSTM_WIDTH), CONV_WIDTH ** -0.5),
        'w_pool': nrm(ks[6], (DEPTH, POOL_GROUPS, POOL_GROUP_DIM, POOL_GROUP_DIM), POOL_GROUP_DIM ** -0.5),
        'pool_scale': gain(ks[7], (DEPTH, POOL_WIDTH)),
        'mlstm_norm_g': gain(ks[8], (DEPTH, MLSTM_WIDTH)),
        'w_out': nrm(ks[9], (DEPTH, D_MIX, D_MODEL), D_MIX ** -0.5),
        'g_mix_pre': gain(ks[10], (DEPTH, D_MODEL)),
        'g_mix_post': gain(ks[11], (DEPTH, D_MODEL)),
        'g_mem': gain(ks[12], (DEPTH, D_MODEL)),
        'g_xattn_pre': gain(ks[13], (DEPTH, D_MODEL)),
        'g_xattn_post': gain(ks[14], (DEPTH, D_MODEL)),
        'wq_x': nrm(ks[15], (DEPTH, D_MODEL, D_MODEL), D_MODEL ** -0.5),
        'wk_x': nrm(ks[16], (DEPTH, D_MODEL, D_MODEL), D_MODEL ** -0.5),
        'wv_x': nrm(ks[17], (DEPTH, D_MODEL, D_MODEL), D_MODEL ** -0.5),
        'wo_x': nrm(ks[18], (DEPTH, D_MODEL, D_MODEL), D_MODEL ** -0.5),
        'g_ffn_pre': gain(ks[19], (DEPTH, D_MODEL)),
        'g_ffn_post': gain(ks[20], (DEPTH, D_MODEL)),
        'w_gate': nrm(ks[21], (DEPTH, D_MODEL, D_FF), D_MODEL ** -0.5),
        'w_up': nrm(ks[22], (DEPTH, D_MODEL, D_FF), D_MODEL ** -0.5),
        'w_down': nrm(ks[23], (DEPTH, D_FF, D_MODEL), D_FF ** -0.5),
    }


def reference(x, mem, w_in, b_gate, conv_qk, w_pool, pool_scale, mlstm_norm_g, w_out,
              g_mix_pre, g_mix_post, g_mem, g_xattn_pre, g_xattn_post,
              wq_x, wk_x, wv_x, wo_x, g_ffn_pre, g_ffn_post, w_gate, w_up, w_down):
    B, S, _ = x.shape
    H, dh = MLSTM_HEADS, MLSTM_HEAD_DIM
    for l in range(DEPTH):
        h = rmsnorm(x, g_mix_pre[l])
        proj = h @ w_in[l]
        pool_out = pool_mixer(proj[..., :OFF_Q], w_pool[l], pool_scale[l])
        qk = jax.nn.silu(causal_depthwise_conv(proj[..., OFF_Q:OFF_V], conv_qk[l])).astype(jnp.float32)
        q = qk[..., :MLSTM_WIDTH].reshape(B, S, H, dh)
        k = qk[..., MLSTM_WIDTH:].reshape(B, S, H, dh)
        v = proj[..., OFF_V:OFF_O].astype(jnp.float32).reshape(B, S, H, dh)
        o_gate = jax.nn.sigmoid(proj[..., OFF_O:OFF_GATE].astype(jnp.float32))
        gates = proj[..., OFF_GATE:].astype(jnp.float32) + b_gate[l].astype(jnp.float32)
        hm = mlstm_heads(q, k, v, gates[..., :H], gates[..., H:])
        hm = hm * lax.rsqrt(jnp.mean(hm * hm, axis=-1, keepdims=True) + EPS)
        m_out = (hm.reshape(B, S, MLSTM_WIDTH) * mlstm_norm_g[l].astype(jnp.float32) * o_gate).astype(x.dtype)
        mix = jnp.concatenate([pool_out, m_out], axis=-1) @ w_out[l]
        x = x + rmsnorm(mix, g_mix_post[l])
        h = rmsnorm(x, g_xattn_pre[l])
        mem_n = rmsnorm(mem, g_mem[l])
        x = x + rmsnorm(cross_attention(h, mem_n, wq_x[l], wk_x[l], wv_x[l], wo_x[l]), g_xattn_post[l])
        h = rmsnorm(x, g_ffn_pre[l])
        x = x + rmsnorm(swiglu(h, w_gate[l], w_up[l], w_down[l]), g_ffn_post[l])
    return x
```

```cpp
#include <hip/hip_runtime.h>
#include <cstdio>
#include <cstdint>

constexpr int BATCH = 4, SEQ = 4096, DM = 1024, T = BATCH * SEQ, NMEM = 256, DEPTH = 2;
constexpr int NH = 4, DH = 128, INC = 2568, DFF = 2816;
constexpr int OFF_Q = 512, OFF_K = 1024, OFF_V = 1536, OFF_O = 2048, OFF_G = 2560;
constexpr float EPS = 1e-6f;

__device__ __forceinline__ float wave_sum(float v) {
#pragma unroll
    for (int o = 1; o < 64; o <<= 1) v += __shfl_xor(v, o);
    return v;
}
__device__ __forceinline__ float wave_max(float v) {
#pragma unroll
    for (int o = 1; o < 64; o <<= 1) v = fmaxf(v, __shfl_xor(v, o));
    return v;
}
__device__ __forceinline__ float sigmoidf_(float x) { return 1.0f / (1.0f + expf(-x)); }
__device__ __forceinline__ float siluf_(float x) { return x / (1.0f + expf(-x)); }

struct GemmP {
    const float* A; const float* B; float* C; const float* colscale;
    long lda, sbk, sbn, ldc;
    long a0, a1, b0, b1, c0, c1, s1;
    int M, N, K, zdiv;
    int mode;
    float alpha;
};
static_assert(sizeof(GemmP) == 4 * 8 + 11 * 8 + 6 * 4, "GemmP has padding");
__global__ void __launch_bounds__(256) k_gemm(GemmP p) {
    __shared__ float As[16][68];
    __shared__ float Bs[16][68];
    const int z = blockIdx.z, z0 = z / p.zdiv, z1 = z % p.zdiv;
    const float* A = p.A + z0 * p.a0 + z1 * p.a1;
    const float* B = p.B + z0 * p.b0 + z1 * p.b1;
    float* C = p.C + z0 * p.c0 + z1 * p.c1;
    const float* cs = p.colscale ? p.colscale + z1 * p.s1 : nullptr;
    const int tm = blockIdx.y * 64, tn = blockIdx.x * 64;
    const int tid = threadIdx.x, tx = tid & 15, ty = tid >> 4;
    float acc[4][4];
#pragma unroll
    for (int i = 0; i < 4; ++i)
#pragma unroll
        for (int j = 0; j < 4; ++j) acc[i][j] = 0.f;
    for (int k0 = 0; k0 < p.K; k0 += 16) {
#pragma unroll
        for (int i = 0; i < 4; ++i) {
            const int idx = tid + 256 * i;
            const int m = idx >> 4, k = idx & 15;
            As[k][m] = A[(long)(tm + m) * p.lda + k0 + k];
            const int kb = idx >> 6, n = idx & 63;
            Bs[kb][n] = (tn + n < p.N) ? B[(long)(k0 + kb) * p.sbk + (long)(tn + n) * p.sbn] : 0.f;
        }
        __syncthreads();
#pragma unroll
        for (int kk = 0; kk < 16; ++kk) {
            const float4 a = *(const float4*)&As[kk][ty * 4];
            const float4 b = *(const float4*)&Bs[kk][tx * 4];
            const float av[4] = {a.x, a.y, a.z, a.w}, bv[4] = {b.x, b.y, b.z, b.w};
#pragma unroll
            for (int i = 0; i < 4; ++i)
#pragma unroll
                for (int j = 0; j < 4; ++j) acc[i][j] += av[i] * bv[j];
        }
        __syncthreads();
    }
#pragma unroll
    for (int i = 0; i < 4; ++i)
#pragma unroll
        for (int j = 0; j < 4; ++j) {
            const int m = tm + ty * 4 + i, n = tn + tx * 4 + j;
            if (n < p.N) {
                float v = acc[i][j];
                float* cp = C + (long)m * p.ldc + n;
                if (p.mode == 1) v = siluf_(*cp) * v;
                else { v *= p.alpha; if (cs) v *= cs[n]; }
                *cp = v;
            }
        }
}

__global__ void __launch_bounds__(256) k_rmsnorm(const float* in, const float* g, const float* base, float* out, int rows) {
    const int row = blockIdx.x * 4 + (threadIdx.x >> 6), lane = threadIdx.x & 63;
    if (row >= rows) return;
    const float4* ip = (const float4*)(in + (size_t)row * DM);
    float4 v[4]; float s = 0.f;
#pragma unroll
    for (int j = 0; j < 4; ++j) { v[j] = ip[lane + 64 * j]; s += v[j].x * v[j].x + v[j].y * v[j].y + v[j].z * v[j].z + v[j].w * v[j].w; }
    const float rs = rsqrtf(wave_sum(s) * (1.0f / DM) + EPS);
    const float4* gp = (const float4*)g;
    float4* op = (float4*)(out + (size_t)row * DM);
#pragma unroll
    for (int j = 0; j < 4; ++j) {
        const float4 gg = gp[lane + 64 * j];
        float4 o; o.x = v[j].x * rs * gg.x; o.y = v[j].y * rs * gg.y; o.z = v[j].z * rs * gg.z; o.w = v[j].w * rs * gg.w;
        if (base) { const float4 b = ((const float4*)(base + (size_t)row * DM))[lane + 64 * j]; o.x += b.x; o.y += b.y; o.z += b.z; o.w += b.w; }
        op[lane + 64 * j] = o;
    }
}

__global__ void __launch_bounds__(256) k_pool(const float* proj, const float* wpool  , const float* scale  , float* mixin) {
    __shared__ float ds[64][129];
    const int g = blockIdx.y, t0 = blockIdx.x * 64, tid = threadIdx.x;
    const int W = 2 << g;
    for (int idx = tid; idx < 64 * 128; idx += 256) {
        const int r = idx >> 7, c = idx & 127;
        const int t = t0 + r, s = t % SEQ;
        const int start = (s + 1 - W) > 0 ? (s + 1 - W) : 0;
        const int cnt = s + 1 - start;
        float sum = 0.f;
        for (int ss = start; ss <= s; ++ss) sum += proj[(size_t)(t - (s - ss)) * INC + g * 128 + c];
        ds[r][c] = sum / (float)cnt - proj[(size_t)t * INC + g * 128 + c];
    }
    __syncthreads();
    const float* w = wpool + (size_t)g * 128 * 128;
    const int dd = tid & 127, rh = tid >> 7;
    for (int r = rh; r < 64; r += 2) {
        float acc = 0.f;
        for (int c = 0; c < 128; ++c) acc += ds[r][c] * w[c * 128 + dd];
        mixin[(size_t)(t0 + r) * DM + g * 128 + dd] = acc * scale[g * 128 + dd];
    }
}

__global__ void __launch_bounds__(256) k_mlstm(const float* proj, const float* convw  , const float* bgate  , float* mixin) {
    const int b = blockIdx.x / NH, h = blockIdx.x % NH;
    const int tid = threadIdx.x, e = tid & 127, half = tid >> 7;
    __shared__ float sq[128], sk[128], sh[2][128], sden[2];
    float C[64];
#pragma unroll
    for (int i = 0; i < 64; ++i) C[i] = 0.f;
    float nst = 0.f;
    const int ch = (tid < 128) ? (h * 128 + tid) : (512 + h * 128 + (tid - 128));
    const float w0 = convw[0 * 1024 + ch], w1 = convw[1 * 1024 + ch], w2 = convw[2 * 1024 + ch], w3 = convw[3 * 1024 + ch];
    float x0 = 0.f, x1 = 0.f, x2 = 0.f;
    const float bi = bgate[h], bf = bgate[4 + h];
    const size_t tb = (size_t)b * SEQ;
    float nx3 = proj[tb * INC + OFF_Q + ch], nig = proj[tb * INC + OFF_G + h], nfg = proj[tb * INC + OFF_G + 4 + h], nv = proj[tb * INC + OFF_V + h * 128 + e];
    for (int s = 0; s < SEQ; ++s) {
        const size_t t = tb + s;
        const float x3 = nx3, v = nv;
        const float ig = nig + bi, fg = nfg + bf;
        if (s + 1 < SEQ) {
            const size_t tn = t + 1;
            nx3 = proj[tn * INC + OFF_Q + ch]; nig = proj[tn * INC + OFF_G + h]; nfg = proj[tn * INC + OFF_G + 4 + h]; nv = proj[tn * INC + OFF_V + h * 128 + e];
        }
        const float cv = siluf_(w0 * x0 + w1 * x1 + w2 * x2 + w3 * x3);
        x0 = x1; x1 = x2; x2 = x3;
        if (tid < 128) sq[tid] = cv * 0.08838834764831845f; else sk[tid - 128] = cv;
        const float fdec = sigmoidf_(fg), iw = expf(ig);
        __syncthreads();
        float hp = 0.f;
#pragma unroll
        for (int i = 0; i < 64; ++i) { const int d = half * 64 + i; C[i] = fdec * C[i] + (iw * sk[d]) * v; hp += sq[d] * C[i]; }
        sh[half][e] = hp;
        if (tid < 128) { nst = fdec * nst + iw * sk[tid]; const float dp = wave_sum(sq[tid] * nst); if ((tid & 63) == 0) sden[tid >> 6] = dp; }
        __syncthreads();
        if (tid < 128) { const float num = sh[0][tid] + sh[1][tid]; const float den = sden[0] + sden[1]; mixin[t * DM + 512 + h * 128 + tid] = num / fmaxf(fabsf(den), 1.0f); }
    }
}
__global__ void __launch_bounds__(256) k_mlstm_post(const float* proj, const float* g  , float* mixin) {
    const int item = blockIdx.x * 4 + (threadIdx.x >> 6), lane = threadIdx.x & 63;
    const int t = item / NH, h = item % NH;
    float* p = mixin + (size_t)t * DM + 512 + h * 128;
    const float a = p[lane], bb = p[lane + 64];
    const float rs = rsqrtf(wave_sum(a * a + bb * bb) * (1.0f / DH) + EPS);
    const float* o = proj + (size_t)t * INC + OFF_O + h * 128;
    p[lane] = a * rs * g[h * 128 + lane] * sigmoidf_(o[lane]);
    p[lane + 64] = bb * rs * g[h * 128 + lane + 64] * sigmoidf_(o[lane + 64]);
}

__global__ void __launch_bounds__(256) k_softmax256(float* S, int rows) {
    const int row = blockIdx.x * 4 + (threadIdx.x >> 6), lane = threadIdx.x & 63;
    if (row >= rows) return;
    float4* p = (float4*)(S + (size_t)row * 256) + lane;
    float4 v = *p;
    const float m = wave_max(fmaxf(fmaxf(v.x, v.y), fmaxf(v.z, v.w)));
    v.x = expf(v.x - m); v.y = expf(v.y - m); v.z = expf(v.z - m); v.w = expf(v.w - m);
    const float inv = 1.0f / wave_sum(v.x + v.y + v.z + v.w);
    v.x *= inv; v.y *= inv; v.z *= inv; v.w *= inv;
    *p = v;
}

static void gemm(hipStream_t st, const float* A, long lda, const float* B, long sbk, long sbn, float* C, long ldc, int M, int N, int K,
                 float alpha = 1.f, int mode = 0, const float* cs = nullptr, int nz = 1, int zdiv = 1,
                 long a0 = 0, long a1 = 0, long b0 = 0, long b1 = 0, long c0 = 0, long c1 = 0, long s1 = 0) {
    GemmP p{}; p.A = A; p.B = B; p.C = C; p.M = M; p.N = N; p.K = K; p.lda = lda; p.sbk = sbk; p.sbn = sbn; p.ldc = ldc;
    p.zdiv = zdiv; p.a0 = a0; p.a1 = a1; p.b0 = b0; p.b1 = b1; p.c0 = c0; p.c1 = c1; p.s1 = s1; p.mode = mode; p.alpha = alpha; p.colscale = cs;
    hipLaunchKernelGGL(k_gemm, dim3((N + 63) / 64, M / 64, nz), dim3(256), 0, st, p);
}

extern "C" void kernel_launch(void* const* d_in, const int* in_sizes, int n_in, void* d_out, int out_size, void* d_ws, size_t ws_size, hipStream_t stream) {
    const float* x_in = (const float*)d_in[0]; const float* mem = (const float*)d_in[1];
    const float* w_in = (const float*)d_in[2]; const float* b_gate = (const float*)d_in[3]; const float* conv_qk = (const float*)d_in[4];
    const float* w_pool = (const float*)d_in[5]; const float* pool_scale = (const float*)d_in[6]; const float* mlstm_g = (const float*)d_in[7];
    const float* w_out = (const float*)d_in[8]; const float* g_mix_pre = (const float*)d_in[9]; const float* g_mix_post = (const float*)d_in[10];
    const float* g_mem = (const float*)d_in[11]; const float* g_xpre = (const float*)d_in[12]; const float* g_xpost = (const float*)d_in[13];
    const float* wq = (const float*)d_in[14]; const float* wk = (const float*)d_in[15]; const float* wv = (const float*)d_in[16]; const float* wo = (const float*)d_in[17];
    const float* g_fpre = (const float*)d_in[18]; const float* g_fpost = (const float*)d_in[19];
    const float* w_gate = (const float*)d_in[20]; const float* w_up = (const float*)d_in[21]; const float* w_down = (const float*)d_in[22];
    float* out = (float*)d_out;
    const size_t MiB = 1u << 20;
    if (ws_size < 256 * MiB) { fprintf(stderr, "kernel_launch: ws too small\n"); return; }
    float* R0 = (float*)d_ws;
    float* R1 = (float*)((char*)d_ws + 64 * MiB);
    float* R2 = (float*)((char*)d_ws + 240 * MiB);
    float* memn = R2; float* Kb = R2 + (size_t)1024 * 1024; float* Vb = R2 + (size_t)2 * 1024 * 1024;

    for (int l = 0; l < DEPTH; ++l) {
        const float* xprev = (l == 0) ? x_in : out;
        hipLaunchKernelGGL(k_rmsnorm, dim3(T / 4), dim3(256), 0, stream, xprev, g_mix_pre + l * DM, (const float*)nullptr, R0, T);
        float* proj = R1;
        gemm(stream, R0, DM, w_in + (size_t)l * DM * INC, INC, 1, proj, INC, T, INC, DM);
        float* mixin = R0;
        hipLaunchKernelGGL(k_pool, dim3(T / 64, 4), dim3(256), 0, stream, proj, w_pool + (size_t)l * 4 * 128 * 128, pool_scale + l * 512, mixin);
        hipLaunchKernelGGL(k_mlstm, dim3(BATCH * NH), dim3(256), 0, stream, proj, conv_qk + (size_t)l * 4 * 1024, b_gate + l * 8, mixin);
        hipLaunchKernelGGL(k_mlstm_post, dim3(T * NH / 4), dim3(256), 0, stream, proj, mlstm_g + l * 512, mixin);
        float* mix = R1;
        gemm(stream, mixin, DM, w_out + (size_t)l * DM * DM, DM, 1, mix, DM, T, DM, DM);
        hipLaunchKernelGGL(k_rmsnorm, dim3(T / 4), dim3(256), 0, stream, mix, g_mix_post + l * DM, xprev, out, T);
        hipLaunchKernelGGL(k_rmsnorm, dim3(T / 4), dim3(256), 0, stream, out, g_xpre + l * DM, (const float*)nullptr, R0, T);
        hipLaunchKernelGGL(k_rmsnorm, dim3(BATCH * NMEM / 4), dim3(256), 0, stream, mem, g_mem + l * DM, (const float*)nullptr, memn, BATCH * NMEM);
        gemm(stream, memn, DM, wk + (size_t)l * DM * DM, DM, 1, Kb, DM, BATCH * NMEM, DM, DM);
        gemm(stream, memn, DM, wv + (size_t)l * DM * DM, DM, 1, Vb, DM, BATCH * NMEM, DM, DM);
        float* qb = R1; float* Sb = R1 + (size_t)T * DM; float* Ob = R0;
        gemm(stream, R0, DM, wq + (size_t)l * DM * DM, DM, 1, qb, DM, T, DM, DM);
        gemm(stream, qb, DM, Kb, 1, DM, Sb, DM, SEQ, 256, 256, 0.0625f, 0, nullptr, BATCH * NH, NH,
             (long)SEQ * DM, 256, (long)NMEM * DM, 256, (long)SEQ * DM, 256);
        hipLaunchKernelGGL(k_softmax256, dim3(T * NH / 4), dim3(256), 0, stream, Sb, T * NH);
        gemm(stream, Sb, DM, Vb, DM, 1, Ob, DM, SEQ, 256, 256, 1.f, 0, nullptr, BATCH * NH, NH,
             (long)SEQ * DM, 256, (long)NMEM * DM, 256, (long)SEQ * DM, 256);
        gemm(stream, Ob, DM, wo + (size_t)l * DM * DM, DM, 1, qb, DM, T, DM, DM);
        hipLaunchKernelGGL(k_rmsnorm, dim3(T / 4), dim3(256), 0, stream, qb, g_xpost + l * DM, out, out, T);
        hipLaunchKernelGGL(k_rmsnorm, dim3(T / 4), dim3(256), 0, stream, out, g_fpre + l * DM, (const float*)nullptr, R0, T);
        float* hid = R1;
        gemm(stream, R0, DM, w_gate + (size_t)l * DM * DFF, DFF, 1, hid, DFF, T, DFF, DM);
        gemm(stream, R0, DM, w_up + (size_t)l * DM * DFF, DFF, 1, hid, DFF, T, DFF, DM, 1.f, 1);
        gemm(stream, hid, DFF, w_down + (size_t)l * DFF * DM, DM, 1, R0, DM, T, DM, DFF);
        hipLaunchKernelGGL(k_rmsnorm, dim3(T / 4), dim3(256), 0, stream, R0, g_fpost + l * DM, out, out, T);
    }
}
```
